# Optimizing an MI355X kernel written in HIP

```python
import jax, jax.numpy as jnp
from jax import lax
import numpy as np

D_MODEL = 1024
BATCH = 2
SEQ = 8192
DEPTH = 4

N_MIXERS = 2
N_HGRN_LAYERS = (DEPTH + N_MIXERS - 1) // N_MIXERS
N_CONV_LAYERS = DEPTH // N_MIXERS
HG_DK = 128
HG_HEADS = D_MODEL // HG_DK
HG_DV = D_MODEL // HG_HEADS
HG_CHUNK = 64
HG_STREAMS = 5
CONV_WIDTH = 3
CONV_STREAMS = 3
MOE_GROUPS = 4
MOE_EXPERTS_PER_GROUP = 8
MOE_EXPERTS = MOE_GROUPS * MOE_EXPERTS_PER_GROUP
MOE_TOPK = 2
MOE_D_EXPERT = D_MODEL // 2
MOE_BLOCK = 256
DN_ALPHA = (2.0 * DEPTH) ** 0.25
DN_BETA = (8.0 * DEPTH) ** -0.25
LN_EPS = 1e-5
RMS_EPS = 1e-6

kernel_name = 'hybrid_hgrn2_shortconv_hmoe_deepnorm_encoder'


def _layer_norm(x, g, b):
    xf = x.astype(jnp.float32)
    mu = jnp.mean(xf, axis=-1, keepdims=True)
    var = jnp.mean(jnp.square(xf - mu), axis=-1, keepdims=True)
    return ((xf - mu) * lax.rsqrt(var + LN_EPS) * g + b).astype(x.dtype)


def _gla_chunked(q, k, v, logf):
    b, h, t, dk = q.shape
    dv = v.shape[-1]
    n = t // HG_CHUNK

    def chunks(a):
        return jnp.moveaxis(a.reshape(b, h, n, HG_CHUNK, a.shape[-1]), 2, 0)

    gc = jnp.cumsum(chunks(logf), axis=-2)
    incl = jnp.tril(jnp.ones((HG_CHUNK, HG_CHUNK), dtype=bool))[:, :, None]

    def step(state, inp):
        qc, kc, vc, g = inp
        o_inter = jnp.einsum('bhik,bhkv->bhiv', qc * jnp.exp(g), state)
        diff = g[:, :, :, None, :] - g[:, :, None, :, :]
        decay = jnp.exp(jnp.where(incl, diff, -jnp.inf))
        scores = jnp.einsum('bhik,bhjk,bhijk->bhij', qc, kc, decay)
        o = o_inter + jnp.einsum('bhij,bhjv->bhiv', scores, vc)
        g_last = g[:, :, -1:, :]
        state = (jnp.exp(g_last[:, :, 0, :, None]) * state
                 + jnp.einsum('bhjk,bhjv->bhkv', kc * jnp.exp(g_last - g), vc))
        return state, o

    s0 = jnp.zeros((b, h, dk, dv), jnp.float32)
    _, o = lax.scan(step, s0, (chunks(q), chunks(k), chunks(v), gc))
    return jnp.moveaxis(o, 0, 2).reshape(b, h, t, dv)


def _hgrn2_mixer(x, w_in, lb, norm_w, w_out):
    b, t, d = x.shape
    q, f_fwd, f_bwd, v, gate = jnp.split(x @ w_in, HG_STREAMS, axis=-1)

    def heads(a):
        return a.reshape(b, t, HG_HEADS, -1).transpose(0, 2, 1, 3).astype(jnp.float32)

    def log_forget(fx, lbd):
        lbd = lbd.astype(jnp.float32).reshape(HG_HEADS, 1, HG_DK)
        return jnp.logaddexp(jnp.log(lbd), jnp.log1p(-lbd) + jax.nn.log_sigmoid(heads(fx)))

    q = jax.nn.silu(heads(q))
    v = heads(v)
    lf_f = log_forget(f_fwd, lb[0])
    lf_b = jnp.flip(log_forget(f_bwd, lb[1]), axis=2)
    o_f = _gla_chunked(q, -jnp.expm1(lf_f), v, lf_f)
    o_b = jnp.flip(_gla_chunked(jnp.flip(q, axis=2), -jnp.expm1(lf_b),
                                jnp.flip(v, axis=2), lf_b), axis=2)
    o = (o_f + o_b).transpose(0, 2, 1, 3)
    o = o * lax.rsqrt(jnp.mean(o * o, axis=-1, keepdims=True) + RMS_EPS) * norm_w.astype(jnp.float32)
    o = o.reshape(b, t, d) * jax.nn.silu(gate.astype(jnp.float32))
    return o.astype(x.dtype) @ w_out


def _short_conv_mixer(x, w_in, conv_w, w_out):
    bg, cg, h = jnp.split(x @ w_in, CONV_STREAMS, axis=-1)
    half = (CONV_WIDTH - 1) // 2
    y = lax.conv_general_dilated(cg * h, conv_w[:, None, :], window_strides=(1,),
                                 padding=[(half, half)],
                                 dimension_numbers=('NWC', 'WIO', 'NWC'),
                                 feature_group_count=x.shape[-1])
    return (bg * y) @ w_out


def _hier_moe(x, w_group, b_group, w_expert, b_expert, w_up, w_down):
    b, t, d = x.shape
    n = b * t
    xf = x.reshape(n, d)
    xr = xf.astype(jnp.float32)
    g_prob = jax.nn.softmax(xr @ w_group.astype(jnp.float32) + b_group.astype(jnp.float32), axis=-1)
    p_group, g_sel = lax.top_k(g_prob, 1)
    e_logits = (xr @ w_expert.astype(jnp.float32) + b_expert.astype(jnp.float32)
                ).reshape(n, MOE_GROUPS, MOE_EXPERTS_PER_GROUP)
    e_logits = jnp.take_along_axis(e_logits, g_sel[:, :, None], axis=1)[:, 0]
    top_logit, top_local = lax.top_k(e_logits, MOE_TOPK)
    gates = p_group * jax.nn.softmax(top_logit, axis=-1)
    expert = g_sel * MOE_EXPERTS_PER_GROUP + top_local

    nk = n * MOE_TOPK
    e_flat = expert.reshape(nk).astype(jnp.int32)
    tok_flat = jnp.arange(nk, dtype=jnp.int32) // MOE_TOPK
    order = jnp.argsort(e_flat)
    e_sorted = e_flat[order]
    counts = jnp.zeros((MOE_EXPERTS,), jnp.int32).at[e_flat].add(1)
    padded = (counts + MOE_BLOCK - 1) // MOE_BLOCK * MOE_BLOCK
    start = jnp.cumsum(counts) - counts
    pad_end = jnp.cumsum(padded)
    pad_start = pad_end - padded
    dest = pad_start[e_sorted] + jnp.arange(nk, dtype=jnp.int32) - start[e_sorted]
    n_rows = -(-nk // MOE_BLOCK) * MOE_BLOCK + MOE_EXPERTS * MOE_BLOCK
    n_blocks = n_rows // MOE_BLOCK
    row_tok = jnp.full((n_rows,), n, jnp.int32).at[dest].set(tok_flat[order])
    row_gate = jnp.zeros((n_rows,), jnp.float32).at[dest].set(gates.reshape(nk)[order])
    block_start = jnp.arange(n_blocks, dtype=jnp.int32) * MOE_BLOCK
    block_expert = jnp.minimum(jnp.searchsorted(pad_end, block_start, side='right'),
                               MOE_EXPERTS - 1).astype(jnp.int32)
    x_pad = jnp.concatenate([xf, jnp.zeros((1, d), xf.dtype)], axis=0)
    xs = x_pad[row_tok].reshape(n_blocks, MOE_BLOCK, d)

    def run_block(args):
        xb, e = args
        hg, hu = jnp.split(xb @ w_up[e], 2, axis=-1)
        return (jax.nn.silu(hg) * hu) @ w_down[e]

    ys = lax.map(run_block, (xs, block_expert)).reshape(n_rows, d)
    out = jnp.zeros((n + 1, d), x.dtype).at[row_tok].add(ys * row_gate[:, None].astype(x.dtype))
    return out[:n].reshape(b, t, d)


def setup_inputs(seed: int = 0) -> dict:
    key = jax.random.key(seed)
    ks = jax.random.split(key, 18)
    d = D_MODEL

    def nrm(k, shape, scale):
        return jax.random.normal(k, shape, jnp.float32) * scale

    return {
        'x': nrm(ks[0], (BATCH, SEQ, d), 1.0),
        'hg_w_in': nrm(ks[1], (N_HGRN_LAYERS, d, HG_STREAMS * d), d ** -0.5),
        'hg_lb_logits': nrm(ks[2], (DEPTH, 2, HG_HEADS * HG_DK), 0.5),
        'hg_norm_w': 1.0 + nrm(ks[3], (N_HGRN_LAYERS, HG_DV), 0.02),
        'hg_w_out': nrm(ks[4], (N_HGRN_LAYERS, d, d), DN_BETA * d ** -0.5),
        'cv_w_in': nrm(ks[5], (N_CONV_LAYERS, d, CONV_STREAMS * d), d ** -0.5),
        'cv_w': nrm(ks[6], (N_CONV_LAYERS, CONV_WIDTH, d), CONV_WIDTH ** -0.5),
        'cv_w_out': nrm(ks[7], (N_CONV_LAYERS, d, d), DN_BETA * d ** -0.5),
        'ln_g': 1.0 + nrm(ks[8], (DEPTH, 2, d), 0.02),
        'ln_b': nrm(ks[9], (DEPTH, 2, d), 0.02),
        'moe_w_group': nrm(ks[10], (DEPTH, d, MOE_GROUPS), d ** -0.5),
        'moe_b_group': nrm(ks[11], (DEPTH, MOE_GROUPS), 0.01),
        'moe_w_expert': nrm(ks[12], (DEPTH, d, MOE_EXPERTS), d ** -0.5),
        'moe_b_expert': nrm(ks[13], (DEPTH, MOE_EXPERTS), 0.01),
        'moe_w_up': nrm(ks[14], (DEPTH, MOE_EXPERTS, d, 2 * MOE_D_EXPERT), d ** -0.5),
        'moe_w_down': nrm(ks[15], (DEPTH, MOE_EXPERTS, MOE_D_EXPERT, d), DN_BETA * MOE_D_EXPERT ** -0.5),
    }


def reference(x, hg_w_in, hg_lb_logits, hg_norm_w, hg_w_out, cv_w_in, cv_w, cv_w_out,
              ln_g, ln_b, moe_w_group, moe_b_group, moe_w_expert, moe_b_expert,
              moe_w_up, moe_w_down):
    lb_all = jnp.cumsum(jax.nn.softmax(hg_lb_logits.astype(jnp.float32), axis=0), axis=0)
    lb_all = lb_all - lb_all[0:1]
    for layer in range(DEPTH):
        j = layer // N_MIXERS
        if layer % N_MIXERS == 0:
            mix = _hgrn2_mixer(x, hg_w_in[j], lb_all[layer], hg_norm_w[j], hg_w_out[j])
        else:
            mix = _short_conv_mixer(x, cv_w_in[j], cv_w[j], cv_w_out[j])
        x = _layer_norm(DN_ALPHA * x + mix, ln_g[layer, 0], ln_b[layer, 0])
        ffn = _hier_moe(x, moe_w_group[layer], moe_b_group[layer], moe_w_expert[layer],
                        moe_b_expert[layer], moe_w_up[layer], moe_w_down[layer])
        x = _layer_norm(DN_ALPHA * x + ffn, ln_g[layer, 1], ln_b[layer, 1])
    return x
```

```cpp
#include <hip/hip_runtime.h>
#include <hip/hip_cooperative_groups.h>
#include <cstdio>
#include <cstdint>
namespace cg = cooperative_groups;

#ifndef MK_MASK
#define MK_MASK 0xff
#endif
#ifndef MK_PER_PHASE
#define MK_PER_PHASE 1
#endif

#define LAS __attribute__((address_space(3)))
#define GAS __attribute__((address_space(1)))
typedef unsigned short bf16;
typedef short bf16x8 __attribute__((ext_vector_type(8)));
typedef float f32x4 __attribute__((ext_vector_type(4)));
typedef float f32x2 __attribute__((ext_vector_type(2)));
typedef unsigned u32x4 __attribute__((ext_vector_type(4)));
typedef unsigned u32x2 __attribute__((ext_vector_type(2)));

constexpr int D = 1024, NTOK = 16384, SEQ = 8192, DEPTH = 4, NH = 8, DK = 128;
constexpr int NE = 32, NG = 4, EG = 8, DE = 512, NR = 36;
constexpr float ALPHA = 1.681792830507429f, LN_EPS = 1e-5f, RMS_EPS = 1e-6f;
constexpr int NWAVES = 8, NTHREADS = 512;
constexpr int LDS_BYTES = 155648;
constexpr int MISC_OFF = 148480;
constexpr int LIST_CAP = 16384;

constexpr size_t MiB = 1u << 20;
constexpr size_t WS_CTL = 0, CTL_BYTES = 1 * MiB;
constexpr size_t WS_LB = 1 * MiB;
constexpr size_t WS_LIST = 2 * MiB;
constexpr size_t WS_GATE = 4 * MiB;
constexpr size_t WS_WHGIN = 8 * MiB;
constexpr size_t WS_WHGOUT = WS_WHGIN + 20 * MiB;
constexpr size_t WS_WCVIN = WS_WHGOUT + 4 * MiB;
constexpr size_t WS_WCVOUT = WS_WCVIN + 12 * MiB;
constexpr size_t WS_WUP = WS_WCVOUT + 4 * MiB;
constexpr size_t WS_WDOWN = WS_WUP + 256 * MiB;
constexpr size_t WS_XB = WS_WDOWN + 128 * MiB;
constexpr size_t WS_X32 = WS_XB + 32 * MiB;
constexpr size_t WS_S = WS_X32 + 64 * MiB;
constexpr size_t WS_Z = WS_S + 7 * 32 * MiB;
constexpr size_t WS_OF = WS_Z + 32 * MiB;
constexpr size_t WS_SLOC = WS_OF + 32 * MiB;
constexpr size_t WS_DSEG = WS_SLOC + 32 * MiB;
constexpr size_t WS_H = WS_DSEG + 1 * MiB;
constexpr size_t WS_YS = WS_H + 40 * MiB;
constexpr size_t WS_END = WS_YS + 64 * MiB;
constexpr size_t STREAM_ELEMS = (size_t)NTOK * D;

__device__ __forceinline__ float bf_lo(unsigned u) { return __builtin_bit_cast(float, u << 16); }
__device__ __forceinline__ float bf_hi(unsigned u) { return __builtin_bit_cast(float, u & 0xffff0000u); }
__device__ __forceinline__ unsigned pk2(float lo, float hi) { unsigned r; asm volatile("v_cvt_pk_bf16_f32 %0, %1, %2" : "=v"(r) : "v"(lo), "v"(hi)); return r; }
__device__ __forceinline__ float fexp(float x) { return __expf(x); }
__device__ __forceinline__ float frcp(float x) { return __builtin_amdgcn_rcpf(x); }
__device__ __forceinline__ float sigm(float x) { x = fminf(fmaxf(x, -30.f), 30.f); return frcp(1.f + fexp(-x)); }
__device__ __forceinline__ float siluf(float x) { return x * sigm(x); }
__device__ __forceinline__ float wave_sum(float v) {
#pragma unroll
    for (int o = 1; o < 64; o <<= 1) v += __shfl_xor(v, o);
    return v;
}

namespace pg8 {
constexpr int BM = 256, BK = 64, HALF = 128, HTB = HALF * BK * 2, STAGE_BYTES = 8 * HTB, NXCD = 8, WGM = 8;
__host__ __device__ __forceinline__ int lds_byte(int r, int c) { const int st = (r >> 4) * 2 + (c >> 5), rr = r & 15, cc = c & 31, ob = rr * 64 + cc * 2; return st * 1024 + (ob ^ (((ob >> 9) & 1) << 5)); }
__host__ __device__ __forceinline__ void stage_rc(int b, int& R, int& C) { const int st = b / 1024, sb = b % 1024, swz = sb ^ (((sb >> 9) & 1) << 5); R = (st >> 1) * 16 + swz / 64; C = (st & 1) * 32 + (swz % 64) / 2; }
__host__ __device__ __forceinline__ int perm32(int rho) { const int n = rho >> 4, i = rho & 15; return 8 * (i >> 2) + 4 * n + (i & 3); }

enum { EPI_HG = 0, EPI_CV = 1, EPI_OUT = 2, EPI_UP = 3, EPI_DOWN = 4 };

struct Unit { int pn, arow0, e, pos0, cnt; const char* bptr; };
struct Desc {
    const bf16* A; const bf16* Bt; int K; int epi; int moe; int gather;
    int nM, nN;
    size_t bstride_e;
    const int* list; const float* gate;
    bf16* S;
    float* X32; const float* lb;
    const LAS int* tb;
    const LAS int* cn;
    const LAS int* emap;
    LAS int* rowtab;
    int nwg, G, c;
};

__device__ __forceinline__ bool next_unit(const Desc& g, int i, Unit& u) {
    const long L = (long)i * g.G + g.c; if (L >= g.nwg) return false;
    int wgid = (int)L; { const int nwg = g.nwg, q = nwg / NXCD, r = nwg % NXCD, xcd = wgid % NXCD, off = wgid / NXCD; wgid = (xcd < r ? xcd * (q + 1) : r * (q + 1) + (xcd - r) * q) + off; }
    if (!g.moe) {
        const int nig = WGM * g.nN, gid = wgid / nig, fm = gid * WGM, gsz = (g.nM - fm) < WGM ? (g.nM - fm) : WGM;
        const int pm = fm + ((wgid % nig) % gsz); u.pn = (wgid % nig) / gsz;
        u.arow0 = pm * BM; u.e = 0; u.pos0 = 0; u.cnt = 0; u.bptr = (const char*)g.Bt + (size_t)u.pn * BM * g.K * 2;
    } else {
        const int mt = wgid >> 2; u.pn = wgid & 3;
        const int e = __builtin_amdgcn_readfirstlane(g.emap[mt]);
        u.e = e; u.pos0 = (mt - __builtin_amdgcn_readfirstlane(g.tb[e])) * BM; u.arow0 = mt * BM; u.cnt = __builtin_amdgcn_readfirstlane(g.cn[e]);
        u.bptr = (const char*)g.Bt + (size_t)e * g.bstride_e + (size_t)u.pn * BM * g.K * 2;
    }
    return true;
}
__device__ __forceinline__ void a_offsets(const Desc& g, const Unit& u, int ui, const int tid, unsigned (&off)[2][2]) {
    int R[2], C[2];
#pragma unroll
    for (int i = 0; i < 2; ++i) stage_rc(tid * 16 + i * 8192, R[i], C[i]);
#pragma unroll
    for (int h = 0; h < 2; ++h)
#pragma unroll
        for (int i = 0; i < 2; ++i) {
            const int r = h * HALF + R[i]; int row;
            if (g.gather) row = g.rowtab[ui * BM + r];
            else row = u.arow0 + r;
            off[h][i] = (unsigned)row * (unsigned)(g.K * 2) + (unsigned)(C[i] * 2);
        }
}

__device__ __forceinline__ void store8(bf16* p, const float (&v)[8]) { u32x4 w; w.x = pk2(v[0], v[1]); w.y = pk2(v[2], v[3]); w.z = pk2(v[4], v[5]); w.w = pk2(v[6], v[7]); *(u32x4*)p = w; }

__device__ __forceinline__ void epilogue(const Desc& g, const Unit& u, const f32x4 (&acc)[2][2][4][2], int wr, int wc, int fr, int fq) {
    const int rl0 = wr * 64 + fr, cl0 = wc * 32 + 8 * fq;
    if (g.epi == EPI_HG) {
        const int stream = u.pn >> 2, colb = (u.pn & 3) * 256 + cl0;
        if (stream == 1 || stream == 2) {
            float lbv[2][8];
#pragma unroll
            for (int bj = 0; bj < 2; ++bj) { const f32x4 a = *(const f32x4*)(g.lb + (stream - 1) * D + colb + bj * HALF), b = *(const f32x4*)(g.lb + (stream - 1) * D + colb + bj * HALF + 4);
                lbv[bj][0] = a[0]; lbv[bj][1] = a[1]; lbv[bj][2] = a[2]; lbv[bj][3] = a[3]; lbv[bj][4] = b[0]; lbv[bj][5] = b[1]; lbv[bj][6] = b[2]; lbv[bj][7] = b[3]; }
            bf16* olf = g.S + (size_t)(2 * stream - 1) * STREAM_ELEMS; bf16* okk = g.S + (size_t)(2 * stream) * STREAM_ELEMS;
#pragma unroll
            for (int ai = 0; ai < 2; ++ai)
#pragma unroll
                for (int m = 0; m < 4; ++m) { const size_t rowoff = (size_t)(u.arow0 + ai * HALF + rl0 + m * 16) * D + colb;
#pragma unroll
                    for (int bj = 0; bj < 2; ++bj) { float lf[8], kk[8];
#pragma unroll
                        for (int k = 0; k < 8; ++k) { float x = acc[ai][bj][m][k >> 2][k & 3]; x = fminf(fmaxf(x, -30.f), 30.f); const float e = fexp(-x), s = frcp(1.f + e), lb = lbv[bj][k];
                            const float f = lb + (1.f - lb) * s; lf[k] = __logf(fmaxf(f, 1e-30f)); kk[k] = (1.f - lb) * (e * s); }
                        store8(olf + rowoff + bj * HALF, lf); store8(okk + rowoff + bj * HALF, kk); } asm volatile("" ::: "memory"); }
        } else {
            bf16* o = g.S + (size_t)(stream == 0 ? 0 : (stream == 3 ? 5 : 6)) * STREAM_ELEMS;
#pragma unroll
            for (int ai = 0; ai < 2; ++ai)
#pragma unroll
                for (int m = 0; m < 4; ++m) { const size_t rowoff = (size_t)(u.arow0 + ai * HALF + rl0 + m * 16) * D + colb;
#pragma unroll
                    for (int bj = 0; bj < 2; ++bj) { float v[8];
#pragma unroll
                        for (int k = 0; k < 8; ++k) { const float x = acc[ai][bj][m][k >> 2][k & 3]; v[k] = (stream == 3) ? x : siluf(x); }
                        store8(o + rowoff + bj * HALF, v); } asm volatile("" ::: "memory"); }
        }
    } else if (g.epi == EPI_CV) {
        if (u.pn < 4) {
#pragma unroll
            for (int ai = 0; ai < 2; ++ai)
#pragma unroll
                for (int m = 0; m < 4; ++m) { const size_t rowoff = (size_t)(u.arow0 + ai * HALF + rl0 + m * 16) * D + u.pn * 256 + cl0;
#pragma unroll
                    for (int bj = 0; bj < 2; ++bj) { float v[8];
#pragma unroll
                        for (int k = 0; k < 8; ++k) v[k] = acc[ai][bj][m][k >> 2][k & 3];
                        store8(g.S + rowoff + bj * HALF, v); } asm volatile("" ::: "memory"); }
        } else {
            bf16* o = g.S + STREAM_ELEMS;
#pragma unroll
            for (int ai = 0; ai < 2; ++ai)
#pragma unroll
                for (int m = 0; m < 4; ++m) { const size_t rowoff = (size_t)(u.arow0 + ai * HALF + rl0 + m * 16) * D + (u.pn - 4) * HALF + cl0; float v[8];
#pragma unroll
                    for (int k = 0; k < 8; ++k) v[k] = acc[ai][0][m][k >> 2][k & 3] * acc[ai][1][m][k >> 2][k & 3];
                    store8(o + rowoff, v); asm volatile("" ::: "memory"); }
        }
    } else if (g.epi == EPI_OUT) {
#pragma unroll
        for (int ai = 0; ai < 2; ++ai)
#pragma unroll
            for (int m = 0; m < 4; ++m) { float* rp = g.X32 + (size_t)(u.arow0 + ai * HALF + rl0 + m * 16) * D + u.pn * 256 + cl0;
#pragma unroll
                for (int bj = 0; bj < 2; ++bj)
#pragma unroll
                    for (int n = 0; n < 2; ++n) { f32x4* p = (f32x4*)(rp + bj * HALF + 4 * n); const f32x4 x = *p; *p = x * ALPHA + acc[ai][bj][m][n]; } asm volatile("" ::: "memory"); }
    } else if (g.epi == EPI_UP) {
#pragma unroll
        for (int ai = 0; ai < 2; ++ai)
#pragma unroll
            for (int m = 0; m < 4; ++m) { const size_t rowoff = (size_t)(u.arow0 + ai * HALF + rl0 + m * 16) * DE + u.pn * HALF + cl0; float v[8];
#pragma unroll
                for (int k = 0; k < 8; ++k) v[k] = siluf(acc[ai][0][m][k >> 2][k & 3]) * acc[ai][1][m][k >> 2][k & 3];
                store8(g.S + rowoff, v); asm volatile("" ::: "memory"); }
    } else {
#pragma unroll
        for (int ai = 0; ai < 2; ++ai)
#pragma unroll
            for (int m = 0; m < 4; ++m) { const int p = u.pos0 + ai * HALF + rl0 + m * 16;
                if (p < u.cnt) { const int slot = g.list[u.e * LIST_CAP + p]; const float gt = g.gate[slot]; bf16* rp = g.S + (size_t)slot * D + u.pn * 256 + cl0;
#pragma unroll
                    for (int bj = 0; bj < 2; ++bj) { float v[8];
#pragma unroll
                        for (int k = 0; k < 8; ++k) v[k] = acc[ai][bj][m][k >> 2][k & 3] * gt;
                        store8(rp + bj * HALF, v); } } asm volatile("" ::: "memory"); }
    }
}

__device__ __forceinline__ void gemm_phase(LAS unsigned char* lds, const Desc& g, const int tid) {
    const int wid = __builtin_amdgcn_readfirstlane(tid >> 6), lane = tid & 63, wr = wid >> 2, wc = wid & 3, fr = lane & 15, fq = lane >> 4;
    const int K = g.K, nt = K / BK;
    unsigned voffB[2];
#pragma unroll
    for (int i = 0; i < 2; ++i) { int R, C; stage_rc(tid * 16 + i * 8192, R, C); const int Rb = (R & ~31) + perm32(R & 31); voffB[i] = (unsigned)(Rb * K + C) * 2u; }
    const size_t kstep = (size_t)(BK * 2);
    const size_t hstep = (size_t)HALF * K * 2;
    const unsigned ldsw = (unsigned)wid * 1024u;
    const int aoff = lds_byte(wr * 64 + fr, fq * 8), boff = lds_byte(wc * 32 + fr, fq * 8);
    const char* const Ab = (const char*)g.A;
#define PG8_SA(b, h) (((b) * 2 + (h)) * HTB)
#define PG8_SB(b, h) ((4 + (b) * 2 + (h)) * HTB)
#define PG8_STAGE(bufoff, gbase, voff) do { _Pragma("unroll") for (int _i = 0; _i < 2; ++_i) \
        __builtin_amdgcn_global_load_lds((const unsigned*)((const char*)(gbase) + (voff)[_i]), (LAS unsigned*)(lds + (bufoff) + ldsw + _i * 8192), 16, 0, 0); } while (0)
#define PG8_LDA(dst, b, h) do { _Pragma("unroll") for (int m = 0; m < 4; ++m) _Pragma("unroll") for (int k = 0; k < 2; ++k) dst[m][k] = *(const LAS bf16x8*)(lds + PG8_SA(b, h) + aoff + m * 2048 + k * 1024); } while (0)
#define PG8_LDB(dst, b, h) do { _Pragma("unroll") for (int n = 0; n < 2; ++n) _Pragma("unroll") for (int k = 0; k < 2; ++k) dst[n][k] = *(const LAS bf16x8*)(lds + PG8_SB(b, h) + boff + n * 2048 + k * 1024); } while (0)
#define PG8_MMA(ai, bj, At, Bt) do { __builtin_amdgcn_s_setprio(1); _Pragma("unroll") for (int m = 0; m < 4; ++m) _Pragma("unroll") for (int n = 0; n < 2; ++n) _Pragma("unroll") for (int k = 0; k < 2; ++k) \
        acc[ai][bj][m][n] = __builtin_amdgcn_mfma_f32_16x16x32_bf16(Bt[n][k], At[m][k], acc[ai][bj][m][n], 0, 0, 0); __builtin_amdgcn_s_setprio(0); } while (0)
#define PG8_WAIT_V(n) asm volatile("s_waitcnt vmcnt(" #n ")" ::: "memory")
#define PG8_WAIT_L(n) asm volatile("s_waitcnt lgkmcnt(" #n ")" ::: "memory")
#define PG8_BAR __builtin_amdgcn_s_barrier()
#define PG8_SCHED __builtin_amdgcn_sched_barrier(0)
    int ui = 0;
    { Unit u0; if (!next_unit(g, 0, u0)) return; }
    f32x4 acc[2][2][4][2];
#pragma unroll
    for (int a = 0; a < 2; ++a)
#pragma unroll
        for (int b = 0; b < 2; ++b)
#pragma unroll
            for (int m = 0; m < 4; ++m)
#pragma unroll
                for (int n = 0; n < 2; ++n) acc[a][b][m][n] = (f32x4){0.f, 0.f, 0.f, 0.f};
    bf16x8 At[4][2], B0[2][2], B1[2][2];
    if (g.gather) {
        Unit uu;
#pragma unroll 1
        for (int k = 0; k < 4; ++k) if (next_unit(g, k, uu) && tid < BM) { int p = uu.pos0 + tid; p = p < uu.cnt ? p : uu.pos0; g.rowtab[k * BM + tid] = g.list[uu.e * LIST_CAP + p] >> 1; }
        __syncthreads();
    }
    unsigned offC[2][2];
    const char* cB;
    { Unit u0; next_unit(g, 0, u0); a_offsets(g, u0, 0, tid, offC); cB = u0.bptr; }
    PG8_STAGE(PG8_SB(0, 0), cB, voffB); PG8_STAGE(PG8_SB(0, 1), cB + hstep, voffB); PG8_STAGE(PG8_SA(0, 0), Ab, offC[0]); PG8_STAGE(PG8_SA(0, 1), Ab, offC[1]);
    if (wr == 1) PG8_BAR;
    PG8_WAIT_V(2); PG8_BAR;
    PG8_STAGE(PG8_SB(1, 0), cB + kstep, voffB); PG8_STAGE(PG8_SA(1, 0), Ab + kstep, offC[0]); PG8_STAGE(PG8_SB(1, 1), cB + hstep + kstep, voffB);
    PG8_WAIT_V(6); PG8_BAR;
    for (;;) {
        bool has_next; const char* nB;
        { Unit nx; has_next = next_unit(g, ui + 1, nx); nB = has_next ? nx.bptr : cB; }
        for (int t = 0; t < nt; t += 2) {
            const bool last = (t == nt - 2);
            const char* a1 = Ab + (size_t)(t + 1) * kstep;
            const char* a2 = last ? Ab : Ab + (size_t)(t + 2) * kstep; const char* b2 = last ? nB : cB + (size_t)(t + 2) * kstep;
            const char* a3 = a2 + kstep; const char* b3 = b2 + kstep;
            PG8_LDB(B0, 0, 0); PG8_LDB(B1, 0, 1); PG8_SCHED; PG8_LDA(At, 0, 0); PG8_STAGE(PG8_SA(1, 1), a1, offC[1]);
            if (last && has_next) { Unit nx; next_unit(g, ui + 1, nx); a_offsets(g, nx, ui + 1, tid, offC); }
            PG8_WAIT_V(8); PG8_WAIT_L(0); PG8_BAR; PG8_MMA(0, 0, At, B0); PG8_MMA(0, 1, At, B1); PG8_BAR; PG8_SCHED;
            PG8_LDA(At, 0, 1); PG8_STAGE(PG8_SB(0, 0), b2, voffB); PG8_STAGE(PG8_SB(0, 1), b2 + hstep, voffB); PG8_STAGE(PG8_SA(0, 0), a2, offC[0]);
            PG8_WAIT_V(8); PG8_WAIT_L(0); PG8_BAR; PG8_MMA(1, 0, At, B0); PG8_MMA(1, 1, At, B1); PG8_BAR; PG8_SCHED;
            PG8_LDB(B0, 1, 0); PG8_LDB(B1, 1, 1); PG8_SCHED; PG8_LDA(At, 1, 0); PG8_STAGE(PG8_SA(0, 1), a2, offC[1]);
            PG8_WAIT_V(8); PG8_WAIT_L(0); PG8_BAR; PG8_MMA(0, 0, At, B0); PG8_MMA(0, 1, At, B1); PG8_BAR; PG8_SCHED;
            PG8_LDA(At, 1, 1); PG8_STAGE(PG8_SB(1, 0), b3, voffB); PG8_STAGE(PG8_SB(1, 1), b3 + hstep, voffB); PG8_STAGE(PG8_SA(1, 0), a3, offC[0]);
            PG8_WAIT_V(8); PG8_WAIT_L(0); PG8_BAR; PG8_MMA(1, 0, At, B0); PG8_MMA(1, 1, At, B1); PG8_BAR; PG8_SCHED;
        }
        if (wr == 0) PG8_BAR;
        { Unit cu; next_unit(g, ui, cu); epilogue(g, cu, acc, wr, wc, fr, fq); }
        if (!has_next) break;
#pragma unroll
        for (int a = 0; a < 2; ++a)
#pragma unroll
            for (int b = 0; b < 2; ++b)
#pragma unroll
                for (int m = 0; m < 4; ++m)
#pragma unroll
                    for (int n = 0; n < 2; ++n) acc[a][b][m][n] = (f32x4){0.f, 0.f, 0.f, 0.f};
        cB = nB; ++ui;
        if (wr == 1) PG8_BAR;
    }
    PG8_WAIT_V(0);
    PG8_BAR;
#undef PG8_SA
#undef PG8_SB
#undef PG8_STAGE
#undef PG8_LDA
#undef PG8_LDB
#undef PG8_MMA
#undef PG8_WAIT_V
#undef PG8_WAIT_L
#undef PG8_BAR
#undef PG8_SCHED
}
}

struct Args {
    const float* x; const float* hg_w_in; const float* hg_lb; const float* hg_norm_w; const float* hg_w_out;
    const float* cv_w_in; const float* cv_w; const float* cv_w_out; const float* ln_g; const float* ln_b;
    const float* w_group; const float* b_group; const float* w_expert; const float* b_expert; const float* w_up; const float* w_down;
    float* out; unsigned char* ws; int ph_lo, ph_hi;
};

__device__ __forceinline__ void transpose_item(const float* W, int K, int N, bf16* WT, int k0, int n0, int orow0, LAS float* scr, int lane) {
#pragma unroll 8
    for (int i = 0; i < 32; ++i) { const int kk = 2 * i + (lane >> 5); scr[kk * 33 + (lane & 31)] = W[(size_t)(k0 + kk) * N + n0 + (lane & 31)]; }
    asm volatile("s_waitcnt lgkmcnt(0)" ::: "memory");
    const int c = lane & 7;
#pragma unroll
    for (int j = 0; j < 4; ++j) { const int n = (lane >> 3) + 8 * j; const LAS float* s = scr + (8 * c) * 33 + n;
        u32x4 o; o.x = pk2(s[0 * 33], s[1 * 33]); o.y = pk2(s[2 * 33], s[3 * 33]); o.z = pk2(s[4 * 33], s[5 * 33]); o.w = pk2(s[6 * 33], s[7 * 33]);
        *(u32x4*)(WT + (size_t)(orow0 + n) * K + k0 + 8 * c) = o; }
    asm volatile("s_waitcnt lgkmcnt(0)" ::: "memory");
}
__device__ __forceinline__ void phase_prologue(const Args& a, LAS unsigned char* lds, int vcu, int G, const int tid, const int bx) {
    const int lane = tid & 63, wave = __builtin_amdgcn_readfirstlane(tid >> 6);
    LAS float* scr = (LAS float*)(lds + wave * 16384);
    const int gw = vcu * NWAVES + wave, NGW = G * NWAVES;
    constexpr int I0 = 2 * 16 * 160, I1 = 2 * 16 * 32, I2 = 2 * 16 * 96, I3 = 2 * 16 * 32, I4 = 128 * 16 * 32, I5 = 128 * 8 * 32;
    constexpr int NITEMS = I0 + I1 + I2 + I3 + I4 + I5;
    unsigned char* ws = a.ws;
    for (int it = gw; it < NITEMS; it += NGW) {
        int r = it; const float* W; bf16* WT; int K, N, cat;
        if (r < I0) { cat = 0; K = 1024; N = 5120; const int mat = r / 2560; r %= 2560; W = a.hg_w_in + (size_t)mat * K * N; WT = (bf16*)(ws + WS_WHGIN) + (size_t)mat * K * N; }
        else if ((r -= I0) < I1) { cat = 1; K = 1024; N = 1024; const int mat = r / 512; r %= 512; W = a.hg_w_out + (size_t)mat * K * N; WT = (bf16*)(ws + WS_WHGOUT) + (size_t)mat * K * N; }
        else if ((r -= I1) < I2) { cat = 2; K = 1024; N = 3072; const int mat = r / 1536; r %= 1536; W = a.cv_w_in + (size_t)mat * K * N; WT = (bf16*)(ws + WS_WCVIN) + (size_t)mat * K * N; }
        else if ((r -= I2) < I3) { cat = 3; K = 1024; N = 1024; const int mat = r / 512; r %= 512; W = a.cv_w_out + (size_t)mat * K * N; WT = (bf16*)(ws + WS_WCVOUT) + (size_t)mat * K * N; }
        else if ((r -= I3) < I4) { cat = 4; K = 1024; N = 1024; const int mat = r / 512; r %= 512; W = a.w_up + (size_t)mat * K * N; WT = (bf16*)(ws + WS_WUP) + (size_t)mat * K * N; }
        else { r -= I4; cat = 5; K = 512; N = 1024; const int mat = r / 256; r %= 256; W = a.w_down + (size_t)mat * K * N; WT = (bf16*)(ws + WS_WDOWN) + (size_t)mat * K * N; }
        const int nblk = N / 32, kb = r / nblk, nb = r % nblk, k0 = 64 * kb, n0 = 32 * nb;
        int orow0 = n0;
        if (cat == 2) { if (n0 >= 2048) { const int c = n0 - 2048; orow0 = 1024 + 256 * (c >> 7) + 128 + (c & 127); } else if (n0 >= 1024) { const int c = n0 - 1024; orow0 = 1024 + 256 * (c >> 7) + (c & 127); } }
        if (cat == 4) { if (n0 >= 512) { const int c = n0 - 512; orow0 = 256 * (c >> 7) + 128 + (c & 127); } else orow0 = 256 * (n0 >> 7) + (n0 & 127); }
        transpose_item(W, K, N, WT, k0, n0, orow0, scr, lane);
    }
    {
        const size_t n4 = (size_t)NTOK * D / 4; const f32x4* xs = (const f32x4*)a.x; f32x4* xd = (f32x4*)(ws + WS_X32); u32x2* xb = (u32x2*)(ws + WS_XB);
        for (size_t i = (size_t)bx * NTHREADS + tid; i < n4; i += (size_t)G * NTHREADS) { const f32x4 v = xs[i]; xd[i] = v; u32x2 w; w.x = pk2(v[0], v[1]); w.y = pk2(v[2], v[3]); xb[i] = w; }
    }
    {
        float* LB = (float*)(ws + WS_LB);
        for (int i = bx * NTHREADS + tid; i < 2 * D; i += G * NTHREADS) {
            const float l0 = a.hg_lb[0 * 2 * D + i], l1 = a.hg_lb[1 * 2 * D + i], l2 = a.hg_lb[2 * 2 * D + i], l3 = a.hg_lb[3 * 2 * D + i];
            const float mx = fmaxf(fmaxf(l0, l1), fmaxf(l2, l3)); const float e0 = expf(l0 - mx), e1 = expf(l1 - mx), e2 = expf(l2 - mx), e3 = expf(l3 - mx); const float inv = 1.f / (e0 + e1 + e2 + e3);
            LB[i] = 0.f; LB[2 * D + i] = (e1 + e2) * inv;
        }
    }
}

namespace gla {
constexpr int QA_OFF = 0, QT_OFF = 17408, KT_OFF = 34816, KHT_OFF = 52224, VT_OFF = 70656, PB_OFF = 89088, WTOT_OFF = 98304, DEC_OFF = 102400, RSP_OFF = 102912, RSTD_OFF = 104960;
constexpr int RS = 272, TS = 144;
constexpr int NSEG = 16, SEGLEN = 512, NCHUNK = 8, CH = 64;
typedef const GAS char* gcp;
__device__ __forceinline__ unsigned ldg32(gcp base, unsigned off) { return *(const GAS unsigned*)(base + off); }
__device__ __forceinline__ unsigned ldg16(gcp base, unsigned off) { return (unsigned)*(const GAS unsigned short*)(base + off); }
__device__ __forceinline__ float ldgf(gcp base, unsigned off) { return *(const GAS float*)(base + off); }

struct Regs { unsigned lf[8], kk[8], q[8], v[8]; };

template <bool FULL>
__device__ __forceinline__ void load_chunk(Regs& R, gcp LF, gcp KK, gcp Q, gcp V, size_t cb, unsigned voff) {
#pragma unroll
    for (int r = 0; r < 8; ++r) { const size_t o = cb + (size_t)r * (D * 2);
        R.lf[r] = ldg32(LF + o, voff); R.kk[r] = ldg32(KK + o, voff); R.v[r] = ldg32(V + o, voff); if (FULL) R.q[r] = ldg32(Q + o, voff); }
}

template <bool FULL, int DIR>
__device__ __forceinline__ void prep_chunk(const Regs& R, LAS unsigned char* lds, int w, int l, float& gt0, float& gt1) {
    float t0 = 0.f, t1 = 0.f;
#pragma unroll
    for (int r = 0; r < 8; ++r) { t0 += bf_lo(R.lf[r]); t1 += bf_hi(R.lf[r]); }
    LAS float* WT = (LAS float*)(lds + WTOT_OFF);
    { f32x2 t; t.x = t0; t.y = t1; *(LAS f32x2*)(WT + w * 128 + 2 * l) = t; }
    __syncthreads();
    float off0 = 0.f, off1 = 0.f, tot0 = 0.f, tot1 = 0.f, ref0 = 0.f, ref1 = 0.f;
#pragma unroll
    for (int ww = 0; ww < 8; ++ww) { const f32x2 t = *(const LAS f32x2*)(WT + ww * 128 + 2 * l); tot0 += t.x; tot1 += t.y;
        const bool before = DIR == 0 ? (ww < w) : (ww > w); off0 += before ? t.x : 0.f; off1 += before ? t.y : 0.f;
        const bool inref = DIR == 0 ? (ww < 4) : (ww >= 4); if (inref) { ref0 += t.x; ref1 += t.y; } }
    gt0 = tot0; gt1 = tot1;
    if (w == 0) { f32x2 d; d.x = fexp(tot0); d.y = fexp(tot1); *(LAS f32x2*)((LAS float*)(lds + DEC_OFF) + 2 * l) = d; }
    float run0 = off0, run1 = off1; unsigned pa[4], pb[4];
#pragma unroll
    for (int pp = 0; pp < 4; ++pp) { const int p = DIR == 0 ? pp : 3 - pp; float h0[2], h1[2];
#pragma unroll
        for (int xx = 0; xx < 2; ++xx) { const int x = DIR == 0 ? xx : 1 - xx, r = 2 * p + x;
            run0 += bf_lo(R.lf[r]); run1 += bf_hi(R.lf[r]); const float g0 = run0, g1 = run1;
            const float k0 = bf_lo(R.kk[r]), k1 = bf_hi(R.kk[r]);
            h0[x] = k0 * fexp(tot0 - g0); h1[x] = k1 * fexp(tot1 - g1);
            if (FULL) { const float q0 = bf_lo(R.q[r]), q1 = bf_hi(R.q[r]); const int rowb = (8 * w + r) * RS + 4 * l;
                *(LAS unsigned*)(lds + QA_OFF + rowb) = pk2(q0 * fexp(g0), q1 * fexp(g1));
                *(LAS unsigned*)(lds + QT_OFF + rowb) = pk2(q0 * fexp(g0 - ref0), q1 * fexp(g1 - ref1));
                *(LAS unsigned*)(lds + KT_OFF + rowb) = pk2(k0 * fexp(ref0 - g0), k1 * fexp(ref1 - g1)); } }
        pa[p] = pk2(h0[0], h0[1]); pb[p] = pk2(h1[0], h1[1]); }
    {
        u32x4 a, b; a.x = pa[0]; a.y = pa[1]; a.z = pa[2]; a.w = pa[3]; b.x = pb[0]; b.y = pb[1]; b.z = pb[2]; b.w = pb[3];
        *(LAS u32x4*)(lds + KHT_OFF + (2 * l) * TS + 16 * w) = a; *(LAS u32x4*)(lds + KHT_OFF + (2 * l + 1) * TS + 16 * w) = b;
        u32x4 c, d;
        c.x = (R.v[0] & 0xffffu) | (R.v[1] << 16); c.y = (R.v[2] & 0xffffu) | (R.v[3] << 16); c.z = (R.v[4] & 0xffffu) | (R.v[5] << 16); c.w = (R.v[6] & 0xffffu) | (R.v[7] << 16);
        d.x = (R.v[0] >> 16) | (R.v[1] & 0xffff0000u); d.y = (R.v[2] >> 16) | (R.v[3] & 0xffff0000u); d.z = (R.v[4] >> 16) | (R.v[5] & 0xffff0000u); d.w = (R.v[6] >> 16) | (R.v[7] & 0xffff0000u);
        *(LAS u32x4*)(lds + VT_OFF + (2 * l) * TS + 16 * w) = c; *(LAS u32x4*)(lds + VT_OFF + (2 * l + 1) * TS + 16 * w) = d;
    }
}

__device__ __forceinline__ void state_update(f32x4 (&S)[8], LAS unsigned char* lds, int w, int q, int c16) {
    bf16x8 vb[2];
    const LAS unsigned char* vtp = lds + VT_OFF + (16 * w + c16) * TS + 16 * q;
    const LAS unsigned char* khp = lds + KHT_OFF + c16 * TS + 16 * q;
    const LAS unsigned char* dcp = lds + DEC_OFF + 16 * q;
#pragma unroll
    for (int s = 0; s < 2; ++s) vb[s] = *(const LAS bf16x8*)(vtp + 64 * s);
#pragma unroll
    for (int t = 0; t < 8; ++t) {
        const f32x4 dc = *(const LAS f32x4*)(dcp + 64 * t);
        S[t] = S[t] * dc;
#pragma unroll
        for (int s = 0; s < 2; ++s) { const bf16x8 ka = *(const LAS bf16x8*)(khp + 16 * t * TS + 64 * s); S[t] = __builtin_amdgcn_mfma_f32_16x16x32_bf16(ka, vb[s], S[t], 0, 0, 0); }
        if (t & 1) asm volatile("" ::: "memory");
    }
}

template <int DIR>
__device__ __forceinline__ void scores(LAS unsigned char* lds, int w, int q, int c16) {
    const int ti = w >> 1;
#pragma unroll
    for (int x = 0; x < 2; ++x) { const int tj = 2 * (w & 1) + x; f32x4 p = (f32x4){0.f, 0.f, 0.f, 0.f};
        const LAS unsigned char* kp = lds + KT_OFF + (16 * tj + c16) * RS + 16 * q; const LAS unsigned char* qp = lds + QT_OFF + (16 * ti + c16) * RS + 16 * q;
#pragma unroll
        for (int s = 0; s < 4; ++s) { const bf16x8 ka = *(const LAS bf16x8*)(kp + 64 * s); const bf16x8 qb = *(const LAS bf16x8*)(qp + 64 * s);
            p = __builtin_amdgcn_mfma_f32_16x16x32_bf16(ka, qb, p, 0, 0, 0); }
        const int i = 16 * ti + c16, j0 = 16 * tj + 4 * q; float pv[4];
#pragma unroll
        for (int r = 0; r < 4; ++r) { const bool keep = DIR == 0 ? (j0 + r <= i) : (j0 + r >= i); pv[r] = keep ? p[r] : 0.f; }
        u32x2 o; o.x = pk2(pv[0], pv[1]); o.y = pk2(pv[2], pv[3]);
        *(LAS u32x2*)(lds + PB_OFF + i * TS + j0 * 2) = o; }
}

__device__ __forceinline__ void outputs(f32x4 (&O)[4], const f32x4 (&S)[8], LAS unsigned char* lds, int w, int q, int c16) {
    bf16x8 sf[4];
#pragma unroll
    for (int s = 0; s < 4; ++s) { u32x4 t; t.x = pk2(S[2 * s][0], S[2 * s][1]); t.y = pk2(S[2 * s][2], S[2 * s][3]); t.z = pk2(S[2 * s + 1][0], S[2 * s + 1][1]); t.w = pk2(S[2 * s + 1][2], S[2 * s + 1][3]); sf[s] = __builtin_bit_cast(bf16x8, t); }
    bf16x8 vb[2];
    const LAS unsigned char* vtp = lds + VT_OFF + (16 * w + c16) * TS + 16 * q;
    const LAS unsigned char* qap = lds + QA_OFF + c16 * RS + 8 * q;
    const LAS unsigned char* pbp = lds + PB_OFF + c16 * TS + 16 * q;
#pragma unroll
    for (int s = 0; s < 2; ++s) vb[s] = *(const LAS bf16x8*)(vtp + 64 * s);
#pragma unroll
    for (int m = 0; m < 4; ++m) { f32x4 o = (f32x4){0.f, 0.f, 0.f, 0.f};
#pragma unroll
        for (int s = 0; s < 4; ++s) { const u32x2 lo = *(const LAS u32x2*)(qap + 16 * m * RS + 64 * s), hi = *(const LAS u32x2*)(qap + 16 * m * RS + 64 * s + 32);
            u32x4 t; t.x = lo.x; t.y = lo.y; t.z = hi.x; t.w = hi.y; o = __builtin_amdgcn_mfma_f32_16x16x32_bf16(__builtin_bit_cast(bf16x8, t), sf[s], o, 0, 0, 0); }
#pragma unroll
        for (int s = 0; s < 2; ++s) { const bf16x8 pa = *(const LAS bf16x8*)(pbp + 16 * m * TS + 64 * s); o = __builtin_amdgcn_mfma_f32_16x16x32_bf16(pa, vb[s], o, 0, 0, 0); }
        O[m] = o; asm volatile("" ::: "memory"); }
}

__device__ __forceinline__ void pass_a(const Args& a, LAS unsigned char* lds, int G, const int tid, const int bx) {
    const int l = tid & 63, w = __builtin_amdgcn_readfirstlane(tid >> 6), q = l >> 4, c16 = l & 15;
    unsigned char* ws = a.ws; gcp SB = (gcp)(ws + WS_S);
    GAS char* SLOC = (GAS char*)(ws + WS_SLOC); GAS char* DSEG = (GAS char*)(ws + WS_DSEG);
    const unsigned voff = (unsigned)((8 * w) * D + 2 * l) * 2u;
    const unsigned soff = (unsigned)((4 * q) * DK + 16 * w + c16) * 4u;
    for (int u = bx; u < 16 * 2 * NSEG; u += G) {
        const int seg = u % NSEG, dir = (u / NSEG) & 1, bh = u / (2 * NSEG), b = bh >> 3, h = bh & 7;
        gcp LF = SB + (size_t)(dir ? 3 : 1) * STREAM_ELEMS * 2; gcp KK = SB + (size_t)(dir ? 4 : 2) * STREAM_ELEMS * 2; gcp V = SB + (size_t)5 * STREAM_ELEMS * 2;
        f32x4 S[8];
#pragma unroll
        for (int t = 0; t < 8; ++t) S[t] = (f32x4){0.f, 0.f, 0.f, 0.f};
        float ds0 = 0.f, ds1 = 0.f;
#pragma unroll 1
        for (int cc = 0; cc < NCHUNK; ++cc) {
            const int ch = dir ? (NCHUNK - 1 - cc) : cc; const size_t cb = (((size_t)b * SEQ + seg * SEGLEN + ch * CH) * D + h * DK) * 2;
            Regs R; load_chunk<false>(R, LF, KK, LF, V, cb, voff);
            __syncthreads();
            float g0, g1;
            if (dir == 0) prep_chunk<false, 0>(R, lds, w, l, g0, g1); else prep_chunk<false, 1>(R, lds, w, l, g0, g1);
            ds0 += g0; ds1 += g1;
            __syncthreads();
            state_update(S, lds, w, q, c16);
        }
        GAS char* so = SLOC + ((size_t)(bh * 2 + dir) * NSEG + seg) * (DK * DK * 4);
#pragma unroll
        for (int t = 0; t < 8; ++t)
#pragma unroll
            for (int r = 0; r < 4; ++r) *(GAS float*)(so + (16 * t + r) * (DK * 4) + soff) = S[t][r];
        if (w == 0) { f32x2 dd; dd.x = ds0; dd.y = ds1; *(GAS f32x2*)(DSEG + ((size_t)(bh * 2 + dir) * NSEG + seg) * (DK * 4) + 8 * l) = dd; }
    }
}

__device__ __forceinline__ void pass_b(const Args& a, int G, const int tid, const int bx) {
    unsigned char* ws = a.ws; float* SLOC = (float*)(ws + WS_SLOC); const float* DSEG = (const float*)(ws + WS_DSEG);
    const int total = 32 * DK * (DK / 4);
    for (int i = bx * NTHREADS + tid; i < total; i += G * NTHREADS) {
        const int d4 = i & 31, k = (i >> 5) & 127, bd = i >> 12, dir = bd & 1;
        f32x4 carry = (f32x4){0.f, 0.f, 0.f, 0.f};
#pragma unroll 4
        for (int ss = 0; ss < NSEG; ++ss) { const int seg = dir ? (NSEG - 1 - ss) : ss;
            f32x4* p = (f32x4*)(SLOC + ((size_t)bd * NSEG + seg) * (DK * DK) + k * DK + 4 * d4); const f32x4 loc = *p; const float dec = fexp(DSEG[((size_t)bd * NSEG + seg) * DK + k]);
            *p = carry; carry = carry * dec + loc; }
    }
}

__device__ __forceinline__ void pass_c(const Args& a, LAS unsigned char* lds, int G, int hl, const int tid, const int bx) {
    const int l = tid & 63, w = __builtin_amdgcn_readfirstlane(tid >> 6), q = l >> 4, c16 = l & 15;
    unsigned char* ws = a.ws; gcp SB = (gcp)(ws + WS_S);
    gcp SLOC = (gcp)(ws + WS_SLOC); GAS char* OF = (GAS char*)(ws + WS_OF); GAS char* Z = (GAS char*)(ws + WS_Z);
    gcp Q = SB; gcp V = SB + (size_t)5 * STREAM_ELEMS * 2; gcp SG = SB + (size_t)6 * STREAM_ELEMS * 2;
    const float nw = a.hg_norm_w[hl * DK + 16 * w + c16];
    const unsigned voff = (unsigned)((8 * w) * D + 2 * l) * 2u;
    const unsigned soff = (unsigned)((4 * q) * DK + 16 * w + c16) * 4u;
    const unsigned ooff = (unsigned)((4 * q) * D + 16 * w + c16) * 2u;
    for (int u = bx; u < 16 * NSEG; u += G) {
        const int seg = u % NSEG, bh = u / NSEG, b = bh >> 3, h = bh & 7;
#pragma unroll 1
        for (int dir = 0; dir < 2; ++dir) {
            gcp LF = SB + (size_t)(dir ? 3 : 1) * STREAM_ELEMS * 2; gcp KK = SB + (size_t)(dir ? 4 : 2) * STREAM_ELEMS * 2;
            f32x4 S[8];
            { gcp si = SLOC + ((size_t)(bh * 2 + dir) * NSEG + seg) * (DK * DK * 4);
#pragma unroll
              for (int t = 0; t < 8; ++t)
#pragma unroll
                  for (int r = 0; r < 4; ++r) S[t][r] = ldgf(si + (16 * t + r) * (DK * 4), soff); }
#pragma unroll 1
            for (int cc = 0; cc < NCHUNK; ++cc) {
                const int ch = dir ? (NCHUNK - 1 - cc) : cc; const size_t cb = (((size_t)b * SEQ + seg * SEGLEN + ch * CH) * D + h * DK) * 2;
                { Regs R; load_chunk<true>(R, LF, KK, Q, V, cb, voff);
                  __syncthreads();
                  float g0, g1;
                  if (dir == 0) prep_chunk<true, 0>(R, lds, w, l, g0, g1); else prep_chunk<true, 1>(R, lds, w, l, g0, g1); }
                __syncthreads();
                if (dir == 0) scores<0>(lds, w, q, c16); else scores<1>(lds, w, q, c16);
                __syncthreads();
                f32x4 O[4];
                outputs(O, S, lds, w, q, c16);
                state_update(S, lds, w, q, c16);
                if (dir == 0) {
#pragma unroll
                    for (int m = 0; m < 4; ++m) {
#pragma unroll
                        for (int r = 0; r < 4; ++r) *(GAS unsigned short*)(OF + cb + (size_t)(16 * m + r) * (D * 2) + ooff) = (unsigned short)(pk2(O[m][r], 0.f) & 0xffffu);
                        asm volatile("" ::: "memory"); }
                } else {
                    LAS float* RSP = (LAS float*)(lds + RSP_OFF); LAS float* RSTD = (LAS float*)(lds + RSTD_OFF);
#pragma unroll
                    for (int m = 0; m < 4; ++m) { f32x4 t;
#pragma unroll
                        for (int r = 0; r < 4; ++r) { const float v = O[m][r] + bf_lo(ldg16((gcp)OF + cb + (size_t)(16 * m + r) * (D * 2), ooff)); O[m][r] = v; float s2 = v * v;
                            s2 += __shfl_xor(s2, 1); s2 += __shfl_xor(s2, 2); s2 += __shfl_xor(s2, 4); s2 += __shfl_xor(s2, 8); t[r] = s2; }
                        if (c16 == 0) *(LAS f32x4*)(RSP + w * 64 + 16 * m + 4 * q) = t;
                        asm volatile("" ::: "memory"); }
                    __syncthreads();
                    if (tid < 64) { float s = 0.f;
#pragma unroll
                        for (int ww = 0; ww < 8; ++ww) s += RSP[ww * 64 + tid];
                        RSTD[tid] = rsqrtf(s * (1.f / DK) + RMS_EPS); }
                    __syncthreads();
#pragma unroll
                    for (int m = 0; m < 4; ++m) { const f32x4 rs = *(const LAS f32x4*)(RSTD + 16 * m + 4 * q);
#pragma unroll
                        for (int r = 0; r < 4; ++r) { const size_t o = cb + (size_t)(16 * m + r) * (D * 2); const float sg = bf_lo(ldg16(SG + o, ooff));
                            *(GAS unsigned short*)(Z + o + ooff) = (unsigned short)(pk2(O[m][r] * rs[r] * nw * sg, 0.f) & 0xffffu); }
                        asm volatile("" ::: "memory"); }
                }
            }
        }
    }
}
}

__device__ __forceinline__ void phase_conv(const Args& a, int G, int cl, const int tid, const int bx) {
    const int lane = tid & 63, wave = tid >> 6;
    unsigned char* ws = a.ws; const bf16* BG = (const bf16*)(ws + WS_S); const bf16* U = BG + STREAM_ELEMS; bf16* Z = (bf16*)(ws + WS_Z);
    const float* cw = a.cv_w + (size_t)cl * 3 * D;
    f32x4 w0[4], w1[4], w2[4];
#pragma unroll
    for (int j = 0; j < 4; ++j) { w0[j] = *(const f32x4*)(cw + 4 * lane + 256 * j); w1[j] = *(const f32x4*)(cw + D + 4 * lane + 256 * j); w2[j] = *(const f32x4*)(cw + 2 * D + 4 * lane + 256 * j); }
    for (int tok = bx * NWAVES + wave; tok < NTOK; tok += G * NWAVES) {
        const int t = tok & (SEQ - 1); const bool hp = t > 0, hn = t < SEQ - 1;
#pragma unroll
        for (int j = 0; j < 4; ++j) { const size_t o = (size_t)tok * D + 4 * lane + 256 * j;
            const u32x2 uc = *(const u32x2*)(U + o); u32x2 up = (u32x2){0u, 0u}, un = (u32x2){0u, 0u}; if (hp) up = *(const u32x2*)(U + o - D); if (hn) un = *(const u32x2*)(U + o + D);
            const u32x2 bg = *(const u32x2*)(BG + o);
            const float y0 = w0[j][0] * bf_lo(up.x) + w1[j][0] * bf_lo(uc.x) + w2[j][0] * bf_lo(un.x), y1 = w0[j][1] * bf_hi(up.x) + w1[j][1] * bf_hi(uc.x) + w2[j][1] * bf_hi(un.x);
            const float y2 = w0[j][2] * bf_lo(up.y) + w1[j][2] * bf_lo(uc.y) + w2[j][2] * bf_lo(un.y), y3 = w0[j][3] * bf_hi(up.y) + w1[j][3] * bf_hi(uc.y) + w2[j][3] * bf_hi(un.y);
            u32x2 z; z.x = pk2(bf_lo(bg.x) * y0, bf_hi(bg.x) * y1); z.y = pk2(bf_lo(bg.y) * y2, bf_hi(bg.y) * y3); *(u32x2*)(Z + o) = z; }
    }
}

__device__ __forceinline__ float sel4(int g, float a, float b, float c, float d) { return g == 0 ? a : (g == 1 ? b : (g == 2 ? c : d)); }
__device__ __forceinline__ void phase_router(const Args& a, LAS unsigned char* lds, int G, int layer, const int tid, const int bx) {
    const int lane = tid & 63, wave = tid >> 6;
    unsigned char* ws = a.ws; float* X32 = (float*)(ws + WS_X32); bf16* XB = (bf16*)(ws + WS_XB);
    int* cnt = (int*)(ws + WS_CTL) + layer * NE; int* list = (int*)(ws + WS_LIST); float* gate = (float*)(ws + WS_GATE);
    LAS float* WR = (LAS float*)lds;
    { const float* wg = a.w_group + (size_t)layer * D * NG; const float* we = a.w_expert + (size_t)layer * D * NE;
      for (int i = tid; i < D * NG; i += NTHREADS) WR[(i & 3) * D + (i >> 2)] = wg[i];
      for (int i = tid; i < D * NE; i += NTHREADS) WR[(4 + (i & 31)) * D + (i >> 5)] = we[i]; }
    __syncthreads();
    const float* lg = a.ln_g + (size_t)(layer * 2 + 0) * D; const float* lb = a.ln_b + (size_t)(layer * 2 + 0) * D;
    f32x4 gv[4], bv[4];
#pragma unroll
    for (int j = 0; j < 4; ++j) { gv[j] = *(const f32x4*)(lg + 4 * lane + 256 * j); bv[j] = *(const f32x4*)(lb + 4 * lane + 256 * j); }
    const float* bgp = a.b_group + layer * NG; const float* bep = a.b_expert + layer * NE;
    for (int tok = bx * NWAVES + wave; tok < NTOK; tok += G * NWAVES) {
        f32x4 v[4]; float s = 0.f;
#pragma unroll
        for (int j = 0; j < 4; ++j) { v[j] = *(const f32x4*)(X32 + (size_t)tok * D + 4 * lane + 256 * j); s += (v[j][0] + v[j][1]) + (v[j][2] + v[j][3]); }
        const float mean = wave_sum(s) * (1.f / D); float s2 = 0.f;
#pragma unroll
        for (int j = 0; j < 4; ++j) { v[j] = v[j] - mean; s2 += (v[j][0] * v[j][0] + v[j][1] * v[j][1]) + (v[j][2] * v[j][2] + v[j][3] * v[j][3]); }
        const float rstd = rsqrtf(wave_sum(s2) * (1.f / D) + LN_EPS);
#pragma unroll
        for (int j = 0; j < 4; ++j) { v[j] = v[j] * rstd * gv[j] + bv[j]; *(f32x4*)(X32 + (size_t)tok * D + 4 * lane + 256 * j) = v[j];
            u32x2 w; w.x = pk2(v[j][0], v[j][1]); w.y = pk2(v[j][2], v[j][3]); *(u32x2*)(XB + (size_t)tok * D + 4 * lane + 256 * j) = w; }
        float L[NR];
#pragma unroll
        for (int e = 0; e < NR; ++e) { float acc = 0.f;
#pragma unroll
            for (int j = 0; j < 4; ++j) { const f32x4 wv = *(const LAS f32x4*)(WR + e * D + 4 * lane + 256 * j); acc += (v[j][0] * wv[0] + v[j][1] * wv[1]) + (v[j][2] * wv[2] + v[j][3] * wv[3]); }
            L[e] = wave_sum(acc); }
        float gl[4];
#pragma unroll
        for (int g = 0; g < 4; ++g) gl[g] = L[g] + bgp[g];
        int gs = 0; float gm = gl[0];
#pragma unroll
        for (int g = 1; g < 4; ++g) if (gl[g] > gm) { gm = gl[g]; gs = g; }
        float den = 0.f;
#pragma unroll
        for (int g = 0; g < 4; ++g) den += expf(gl[g] - gm);
        const float pg = 1.f / den;
        float el[8];
#pragma unroll
        for (int e = 0; e < 8; ++e) el[e] = sel4(gs, L[4 + e], L[12 + e], L[20 + e], L[28 + e]) + sel4(gs, bep[e], bep[8 + e], bep[16 + e], bep[24 + e]);
        int i0 = 0; float m0 = el[0];
#pragma unroll
        for (int e = 1; e < 8; ++e) if (el[e] > m0) { m0 = el[e]; i0 = e; }
        int i1 = -1; float m1 = -INFINITY;
#pragma unroll
        for (int e = 0; e < 8; ++e) if (e != i0 && el[e] > m1) { m1 = el[e]; i1 = e; }
        const float e1 = expf(m1 - m0); const float w0 = 1.f / (1.f + e1), w1 = e1 / (1.f + e1);
        if (lane == 0) {
            const int ex0 = gs * EG + i0, ex1 = gs * EG + i1;
            const int p0 = atomicAdd(cnt + ex0, 1); list[ex0 * LIST_CAP + p0] = tok * 2; gate[tok * 2] = pg * w0;
            const int p1 = atomicAdd(cnt + ex1, 1); list[ex1 * LIST_CAP + p1] = tok * 2 + 1; gate[tok * 2 + 1] = pg * w1;
        }
    }
}

__device__ __forceinline__ void phase_combine(const Args& a, int G, int layer, const int tid, const int bx) {
    const int lane = tid & 63, wave = tid >> 6;
    unsigned char* ws = a.ws; float* X32 = (float*)(ws + WS_X32); bf16* XB = (bf16*)(ws + WS_XB); const bf16* YS = (const bf16*)(ws + WS_YS);
    float* dst = (layer == DEPTH - 1) ? a.out : X32;
    const float* lg = a.ln_g + (size_t)(layer * 2 + 1) * D; const float* lb = a.ln_b + (size_t)(layer * 2 + 1) * D;
    f32x4 gv[4], bv[4];
#pragma unroll
    for (int j = 0; j < 4; ++j) { gv[j] = *(const f32x4*)(lg + 4 * lane + 256 * j); bv[j] = *(const f32x4*)(lb + 4 * lane + 256 * j); }
    for (int tok = bx * NWAVES + wave; tok < NTOK; tok += G * NWAVES) {
        f32x4 v[4]; float s = 0.f;
#pragma unroll
        for (int j = 0; j < 4; ++j) { const size_t o = (size_t)tok * D + 4 * lane + 256 * j; const f32x4 x = *(const f32x4*)(X32 + o);
            const u32x2 y0 = *(const u32x2*)(YS + (size_t)(2 * tok) * D + 4 * lane + 256 * j), y1 = *(const u32x2*)(YS + (size_t)(2 * tok + 1) * D + 4 * lane + 256 * j);
            v[j][0] = x[0] * ALPHA + (bf_lo(y0.x) + bf_lo(y1.x)); v[j][1] = x[1] * ALPHA + (bf_hi(y0.x) + bf_hi(y1.x)); v[j][2] = x[2] * ALPHA + (bf_lo(y0.y) + bf_lo(y1.y)); v[j][3] = x[3] * ALPHA + (bf_hi(y0.y) + bf_hi(y1.y));
            s += (v[j][0] + v[j][1]) + (v[j][2] + v[j][3]); }
        const float mean = wave_sum(s) * (1.f / D); float s2 = 0.f;
#pragma unroll
        for (int j = 0; j < 4; ++j) { v[j] = v[j] - mean; s2 += (v[j][0] * v[j][0] + v[j][1] * v[j][1]) + (v[j][2] * v[j][2] + v[j][3] * v[j][3]); }
        const float rstd = rsqrtf(wave_sum(s2) * (1.f / D) + LN_EPS);
#pragma unroll
        for (int j = 0; j < 4; ++j) { v[j] = v[j] * rstd * gv[j] + bv[j]; *(f32x4*)(dst + (size_t)tok * D + 4 * lane + 256 * j) = v[j];
            u32x2 w; w.x = pk2(v[j][0], v[j][1]); w.y = pk2(v[j][2], v[j][3]); *(u32x2*)(XB + (size_t)tok * D + 4 * lane + 256 * j) = w; }
    }
}

constexpr int N_PHASES = 1 + 9 * DEPTH;
__host__ __device__ inline bool phase_empty(int ph) { if (ph == 0) return false; const int l = (ph - 1) / 9, s = (ph - 1) % 9; return (l & 1) && (s == 2 || s == 3); }

__global__ void __launch_bounds__(NTHREADS, 2) fwd_kernel(Args a_in) {
    extern __shared__ __attribute__((aligned(16))) unsigned char lds_raw[];
    cg::grid_group grid = cg::this_grid();
    const int ph_lo = a_in.ph_lo, ph_hi = a_in.ph_hi;
    for (int ph = ph_lo; ph < ph_hi; ++ph) {
        if (phase_empty(ph)) continue;
        int tid = threadIdx.x, bx = blockIdx.x, G = gridDim.x; unsigned ldsb = 0u;
        const __attribute__((address_space(4))) char* kp = (const __attribute__((address_space(4))) char*)__builtin_amdgcn_kernarg_segment_ptr();
        asm volatile("" : "+v"(tid), "+s"(bx), "+s"(G), "+s"(ldsb), "+s"(kp));
        const Args& a = *(const Args*)(const char*)kp;
        unsigned char* ws = a.ws;
        LAS unsigned char* lds = (LAS unsigned char*)lds_raw + ldsb;
        const int vcu = (G % 8 == 0) ? (bx % 8) * (G / 8) + bx / 8 : bx;
        if (ph == 0) { if (MK_MASK & 1) phase_prologue(a, lds, vcu, G, tid, bx); }
        else {
            const int layer = (ph - 1) / 9, sub = (ph - 1) % 9, hl = layer >> 1; const bool conv = layer & 1;
            if ((sub == 0 || sub == 4) && (MK_MASK & 2)) {
                pg8::Desc g; g.A = (sub == 0) ? (const bf16*)(ws + WS_XB) : (const bf16*)(ws + WS_Z); g.K = D; g.moe = 0; g.gather = 0; g.nM = NTOK / 256; g.bstride_e = 0; g.list = nullptr; g.gate = nullptr;
                g.S = (bf16*)(ws + WS_S); g.X32 = (float*)(ws + WS_X32); g.lb = (const float*)(ws + WS_LB) + hl * 2 * D; g.tb = nullptr; g.cn = nullptr; g.emap = nullptr; g.rowtab = nullptr; g.G = G; g.c = bx;
                if (sub == 0) { if (!conv) { g.Bt = (const bf16*)(ws + WS_WHGIN) + (size_t)hl * 5120 * D; g.nN = 20; g.epi = pg8::EPI_HG; } else { g.Bt = (const bf16*)(ws + WS_WCVIN) + (size_t)hl * 3072 * D; g.nN = 12; g.epi = pg8::EPI_CV; } }
                else { g.Bt = (const bf16*)(ws + (conv ? WS_WCVOUT : WS_WHGOUT)) + (size_t)hl * D * D; g.nN = 4; g.epi = pg8::EPI_OUT; }
                g.nwg = g.nM * g.nN;
                pg8::gemm_phase(lds, g, tid);
            } else if ((sub == 6 || sub == 7) && (MK_MASK & 4)) {
                LAS int* tb = (LAS int*)(lds + MISC_OFF); LAS int* cn = tb + 64;
                const int* cnt = (const int*)(ws + WS_CTL) + layer * NE;
                if (tid < NE) cn[tid] = __hip_atomic_load(cnt + tid, __ATOMIC_RELAXED, __HIP_MEMORY_SCOPE_AGENT);
                __syncthreads();
                if (tid == 0) { int s = 0;
#pragma unroll 1
                    for (int e = 0; e < NE; ++e) { tb[e] = s; const int nt = (cn[e] + 255) >> 8;
#pragma unroll 1
                        for (int k = 0; k < nt; ++k) tb[128 + s + k] = e;
                        s += nt; }
                    tb[NE] = s; }
                __syncthreads();
                pg8::Desc g; g.moe = 1; g.nM = 0; g.nN = 4; g.list = (const int*)(ws + WS_LIST); g.gate = (const float*)(ws + WS_GATE); g.X32 = nullptr; g.lb = nullptr; g.tb = tb; g.cn = cn; g.emap = tb + 128; g.rowtab = tb + 384; g.G = G; g.c = bx;
                g.nwg = __builtin_amdgcn_readfirstlane(tb[NE]) * 4;
                if (sub == 6) { g.A = (const bf16*)(ws + WS_XB); g.Bt = (const bf16*)(ws + WS_WUP) + (size_t)layer * NE * D * D; g.K = D; g.epi = pg8::EPI_UP; g.gather = 1; g.bstride_e = (size_t)D * D * 2; g.S = (bf16*)(ws + WS_H); }
                else { g.A = (const bf16*)(ws + WS_H); g.Bt = (const bf16*)(ws + WS_WDOWN) + (size_t)layer * NE * D * DE; g.K = DE; g.epi = pg8::EPI_DOWN; g.gather = 0; g.bstride_e = (size_t)D * DE * 2; g.S = (bf16*)(ws + WS_YS); }
                pg8::gemm_phase(lds, g, tid);
            } else if (sub == 1) { if (!conv) { if (MK_MASK & 8) gla::pass_a(a, lds, G, tid, bx); } else if (MK_MASK & 16) phase_conv(a, G, hl, tid, bx); }
            else if (sub == 2) { if (MK_MASK & 16) gla::pass_b(a, G, tid, bx); }
            else if (sub == 3) { if (MK_MASK & 32) gla::pass_c(a, lds, G, hl, tid, bx); }
            else if (sub == 5) { if (MK_MASK & 64) phase_router(a, lds, G, layer, tid, bx); }
            else if (MK_MASK & 128) phase_combine(a, G, layer, tid, bx);
        }
        if (ph + 1 < ph_hi) grid.sync();
    }
}

extern "C" void kernel_launch(void* const* d_in, const int* in_sizes, int n_in, void* d_out, int out_size, void* d_ws, size_t ws_size, hipStream_t stream) {
    static int grid = 0;
    if (grid == 0) {
        if (n_in != 16 || out_size != NTOK * D || ws_size < WS_END) { fprintf(stderr, "kernel_launch: unexpected shapes (n_in %d out %d ws %zu need %zu)\n", n_in, out_size, ws_size, (size_t)WS_END); grid = -1; return; }
        int dev = 0, cus = 0, per_cu = 0;
        (void)hipGetDevice(&dev); (void)hipDeviceGetAttribute(&cus, hipDeviceAttributeMultiprocessorCount, dev);
        if (hipFuncSetAttribute((const void*)fwd_kernel, hipFuncAttributeMaxDynamicSharedMemorySize, LDS_BYTES) != hipSuccess) { fprintf(stderr, "kernel_launch: hipFuncSetAttribute failed\n"); grid = -1; return; }
        (void)hipOccupancyMaxActiveBlocksPerMultiprocessor(&per_cu, (const void*)fwd_kernel, NTHREADS, LDS_BYTES);
        if (per_cu < 1) { fprintf(stderr, "kernel_launch: occupancy query reports %d blocks per CU\n", per_cu); grid = -1; return; }
        grid = cus;
    }
    if (grid < 0) return;
    (void)hipMemsetAsync((char*)d_ws + WS_CTL, 0, CTL_BYTES, stream);
    Args a{};
    a.x = (const float*)d_in[0]; a.hg_w_in = (const float*)d_in[1]; a.hg_lb = (const float*)d_in[2]; a.hg_norm_w = (const float*)d_in[3]; a.hg_w_out = (const float*)d_in[4];
    a.cv_w_in = (const float*)d_in[5]; a.cv_w = (const float*)d_in[6]; a.cv_w_out = (const float*)d_in[7]; a.ln_g = (const float*)d_in[8]; a.ln_b = (const float*)d_in[9];
    a.w_group = (const float*)d_in[10]; a.b_group = (const float*)d_in[11]; a.w_expert = (const float*)d_in[12]; a.b_expert = (const float*)d_in[13]; a.w_up = (const float*)d_in[14]; a.w_down = (const float*)d_in[15];
    a.out = (float*)d_out; a.ws = (unsigned char*)d_ws;
#if MK_PER_PHASE
    for (int ph = 0; ph < N_PHASES; ++ph) {
        if (phase_empty(ph)) continue;
        a.ph_lo = ph; a.ph_hi = ph + 1;
        hipLaunchKernelGGL(fwd_kernel, dim3(grid), dim3(NTHREADS), LDS_BYTES, stream, a);
    }
#else
    a.ph_lo = 0; a.ph_hi = N_PHASES;
    void* args[] = {&a};
    hipError_t e = hipLaunchCooperativeKernel((void*)fwd_kernel, dim3(grid), dim3(NTHREADS), args, LDS_BYTES, stream);
    if (e != hipSuccess) fprintf(stderr, "kernel_launch: cooperative launch failed: %s (grid %d)\n", hipGetErrorString(e), grid);
#endif
}
```
